# Optimizing an MI355X kernel written in HIP

```python
import math
import jax, jax.numpy as jnp
from jax import lax
import numpy as np

D_MODEL = 1024
BATCH = 8
SEQ = 2048
DEPTH = 2

CHUNK = 64
Q_BLOCK = 128
MEM_LEN = 256

A_HEADS = 8
A_HEAD_DIM = 64
A_LEFT_CHUNKS = 8
A_BAND = (A_LEFT_CHUNKS + 1) * CHUNK
A_REL_MIN = -(CHUNK - 1)
A_REL_MAX = 256
A_REL_SIZE = A_REL_MAX - A_REL_MIN + 1

B_HEADS = 8
B_Q_LORA = 384
B_KV_LORA = 256
B_NOPE = 64
B_ROPE = 32
B_V = 64
ROPE_BASE = 10000.0

C_HEADS = 8
C_HEAD_DIM = 64

N_BRANCHES = 3
BRANCH_WIDTH = 512

A_COLS = 3 * A_HEADS * A_HEAD_DIM
B_COLS = B_Q_LORA + B_KV_LORA + B_ROPE
C_COLS = 3 * C_HEADS * C_HEAD_DIM
GATE_COLS = N_BRANCHES * D_MODEL
IN_COLS = A_COLS + B_COLS + C_COLS + C_HEADS + GATE_COLS

XA_HEADS = 4
XA_HEAD_DIM = 128

FFN_HIDDEN = ((8 * D_MODEL // 3 + 255) // 256) * 256

LN_EPS = 1e-5
RMS_EPS = 1e-6

kernel_name = "hybrid_chunk_causal_gated_encoder"


def layer_norm(x, g, b):
    xf = x.astype(jnp.float32)
    mu = jnp.mean(xf, axis=-1, keepdims=True)
    var = jnp.mean(jnp.square(xf - mu), axis=-1, keepdims=True)
    return ((xf - mu) * lax.rsqrt(var + LN_EPS) * g.astype(jnp.float32) + b.astype(jnp.float32)).astype(x.dtype)


def rms_norm(x, g):
    xf = x.astype(jnp.float32)
    ms = jnp.mean(jnp.square(xf), axis=-1, keepdims=True)
    return (xf * lax.rsqrt(ms + RMS_EPS) * g.astype(jnp.float32)).astype(x.dtype)


def rope(x, pos):
    half = x.shape[-1] // 2
    inv_freq = ROPE_BASE ** (-jnp.arange(half, dtype=jnp.float32) / half)
    ang = pos.astype(jnp.float32)[..., None] * inv_freq
    ang = ang.reshape(ang.shape[:2] + (1,) * (x.ndim - 3) + (half,))
    cos, sin = jnp.cos(ang), jnp.sin(ang)
    x1 = x[..., :half].astype(jnp.float32)
    x2 = x[..., half:].astype(jnp.float32)
    return jnp.concatenate([x1 * cos - x2 * sin, x2 * cos + x1 * sin], axis=-1).astype(x.dtype)


def split_cols(h, widths):
    out, off = [], 0
    for w in widths:
        out.append(h[..., off:off + w])
        off += w
    return out


def chunked_relpos_attention(q, k, v, rel_bias):
    B, S, H, Dh = q.shape
    nc = S // CHUNK
    pad = A_LEFT_CHUNKS * CHUNK
    kp = jnp.pad(k, ((0, 0), (pad, 0), (0, 0), (0, 0))).reshape(B, nc + A_LEFT_CHUNKS, CHUNK, H, Dh)
    vp = jnp.pad(v, ((0, 0), (pad, 0), (0, 0), (0, 0))).reshape(B, nc + A_LEFT_CHUNKS, CHUNK, H, Dh)
    k_band = jnp.concatenate([kp[:, j:j + nc] for j in range(A_LEFT_CHUNKS + 1)], axis=2)
    v_band = jnp.concatenate([vp[:, j:j + nc] for j in range(A_LEFT_CHUNKS + 1)], axis=2)
    qc = q.reshape(B, nc, CHUNK, H, Dh)
    s = jnp.einsum('bcqhd,bckhd->bchqk', qc, k_band).astype(jnp.float32) * (Dh ** -0.5)
    qi = jnp.arange(CHUNK)[:, None]
    kj = jnp.arange(A_BAND)[None, :]
    rel = pad + qi - kj
    idx = jnp.clip(rel, A_REL_MIN, A_REL_MAX) - A_REL_MIN
    bias = rel_bias.astype(jnp.float32)[:, idx]
    s = s + bias[None, None]
    chunk_ids = jnp.arange(nc)[:, None]
    valid = (chunk_ids * CHUNK - pad + kj) >= 0
    s = jnp.where(valid[None, :, None, None, :], s, -jnp.inf)
    p = jax.nn.softmax(s, axis=-1).astype(v.dtype)
    o = jnp.einsum('bchqk,bckhd->bcqhd', p, v_band)
    return o.reshape(B, S, H * Dh)


def mla_attention(c_q, c_kv, k_rope_in, pos, q_norm_g, kv_norm_g, w_uq, w_ukv):
    B, S, _ = c_q.shape
    q = (rms_norm(c_q, q_norm_g) @ w_uq).reshape(B, S, B_HEADS, B_NOPE + B_ROPE)
    q_nope = q[..., :B_NOPE]
    q_pe = rope(q[..., B_NOPE:], pos)
    kv = (rms_norm(c_kv, kv_norm_g) @ w_ukv).reshape(B, S, B_HEADS, B_NOPE + B_V)
    k_nope, v = kv[..., :B_NOPE], kv[..., B_NOPE:]
    k_pe = rope(k_rope_in, pos)
    scale = (B_NOPE + B_ROPE) ** -0.5
    key_chunk = jnp.arange(S) // CHUNK

    def block(i):
        start = i * Q_BLOCK
        qn = lax.dynamic_slice_in_dim(q_nope, start, Q_BLOCK, axis=1)
        qp = lax.dynamic_slice_in_dim(q_pe, start, Q_BLOCK, axis=1)
        s = (jnp.einsum('bqhd,bkhd->bhqk', qn, k_nope).astype(jnp.float32)
             + jnp.einsum('bqhr,bkr->bhqk', qp, k_pe).astype(jnp.float32)) * scale
        q_chunk = (start + jnp.arange(Q_BLOCK)) // CHUNK
        mask = key_chunk[None, :] <= q_chunk[:, None]
        s = jnp.where(mask, s, -jnp.inf)
        p = jax.nn.softmax(s, axis=-1).astype(v.dtype)
        return jnp.einsum('bhqk,bkhd->bqhd', p, v)

    o = lax.map(block, jnp.arange(S // Q_BLOCK))
    return o.transpose(1, 0, 2, 3, 4).reshape(B, S, B_HEADS * B_V)


def forgetting_attention(q, k, v, f_logit):
    B, S, H, Dh = q.shape
    log_f = jax.nn.log_sigmoid(f_logit.astype(jnp.float32))
    F = jnp.cumsum(log_f, axis=1).transpose(0, 2, 1)
    scale = Dh ** -0.5
    key_pos = jnp.arange(S)

    def block(i):
        start = i * Q_BLOCK
        qb = lax.dynamic_slice_in_dim(q, start, Q_BLOCK, axis=1)
        Fq = lax.dynamic_slice_in_dim(F, start, Q_BLOCK, axis=2)
        s = jnp.einsum('bqhd,bkhd->bhqk', qb, k).astype(jnp.float32) * scale
        s = s + Fq[..., :, None] - F[..., None, :]
        mask = key_pos[None, :] <= (start + jnp.arange(Q_BLOCK))[:, None]
        s = jnp.where(mask, s, -jnp.inf)
        p = jax.nn.softmax(s, axis=-1).astype(v.dtype)
        return jnp.einsum('bhqk,bkhd->bqhd', p, v)

    o = lax.map(block, jnp.arange(S // Q_BLOCK))
    return o.transpose(1, 0, 2, 3, 4).reshape(B, S, H * Dh)


def hybrid_mixer(x, pos, w_in, b_gate, b_forget, a_rel_bias, b_q_norm, b_kv_norm,
                 b_w_uq, b_w_ukv, w_branch, w_out):
    B, S, _ = x.shape
    h = x @ w_in
    a_qkv, b_cq, b_ckv, b_kr, c_qkv, c_f, g = split_cols(
        h, [A_COLS, B_Q_LORA, B_KV_LORA, B_ROPE, C_COLS, C_HEADS, GATE_COLS])
    a_qkv = a_qkv.reshape(B, S, 3, A_HEADS, A_HEAD_DIM)
    y_a = chunked_relpos_attention(a_qkv[:, :, 0], a_qkv[:, :, 1], a_qkv[:, :, 2], a_rel_bias)
    y_b = mla_attention(b_cq, b_ckv, b_kr, pos, b_q_norm, b_kv_norm, b_w_uq, b_w_ukv)
    c_qkv = c_qkv.reshape(B, S, 3, C_HEADS, C_HEAD_DIM)
    y_c = forgetting_attention(c_qkv[:, :, 0], c_qkv[:, :, 1], c_qkv[:, :, 2], c_f + b_forget)
    branches = jnp.stack([y_a, y_b, y_c], axis=2)
    proj = jnp.einsum('bsnw,nwd->bsnd', branches, w_branch)
    gates = jax.nn.sigmoid(g.reshape(B, S, N_BRANCHES, D_MODEL) + b_gate)
    merged = jnp.sum(gates * proj, axis=2)
    return merged @ w_out


def memory_cross_attention(x, mem, w_q, w_kv, w_o):
    B, S, _ = x.shape
    M = mem.shape[1]
    q = (x @ w_q).reshape(B, S, XA_HEADS, XA_HEAD_DIM)
    kv = (mem @ w_kv).reshape(B, M, 2, XA_HEADS, XA_HEAD_DIM)
    s = jnp.einsum('bqhd,bkhd->bhqk', q, kv[:, :, 0]).astype(jnp.float32) * (XA_HEAD_DIM ** -0.5)
    p = jax.nn.softmax(s, axis=-1).astype(x.dtype)
    o = jnp.einsum('bhqk,bkhd->bqhd', p, kv[:, :, 1]).reshape(B, S, XA_HEADS * XA_HEAD_DIM)
    return o @ w_o


def swiglu_ffn(x, w_gu, w_down):
    gu = x @ w_gu
    g, u = gu[..., :FFN_HIDDEN], gu[..., FFN_HIDDEN:]
    return (jax.nn.silu(g) * u) @ w_down


def setup_inputs(seed: int = 0) -> dict:
    key = jax.random.key(seed)
    ks = jax.random.split(key, 24)
    f32 = jnp.float32
    L = DEPTH
    beta = (8 * DEPTH) ** -0.25

    def w(k, shape, fan_in, scale=1.0):
        return jax.random.normal(k, shape, f32) * (scale * fan_in ** -0.5)

    def gain(k, shape):
        return 1.0 + 0.05 * jax.random.normal(k, shape, f32)

    def small(k, shape, s=0.02):
        return s * jax.random.normal(k, shape, f32)

    x = jax.random.normal(ks[0], (BATCH, SEQ, D_MODEL), f32)
    mem = jax.random.normal(ks[1], (BATCH, MEM_LEN, D_MODEL), f32)
    offs = jax.random.randint(ks[2], (BATCH, 1), 0, 16) * CHUNK
    positions = (jnp.arange(SEQ, dtype=jnp.int32)[None, :] + offs).astype(jnp.int32)

    return {
        "x": x,
        "mem": mem,
        "positions": positions,
        "ln_mix_g": gain(ks[3], (L, D_MODEL)),
        "ln_mix_b": small(ks[4], (L, D_MODEL)),
        "w_in": w(ks[5], (L, D_MODEL, IN_COLS), D_MODEL),
        "b_gate": small(ks[6], (L, N_BRANCHES, D_MODEL)),
        "b_forget": 3.0 + 0.5 * jax.random.normal(ks[7], (L, C_HEADS), f32),
        "a_rel_bias": small(ks[8], (L, A_HEADS, A_REL_SIZE), 0.5),
        "b_q_norm": gain(ks[9], (L, B_Q_LORA)),
        "b_kv_norm": gain(ks[10], (L, B_KV_LORA)),
        "b_w_uq": w(ks[11], (L, B_Q_LORA, B_HEADS * (B_NOPE + B_ROPE)), B_Q_LORA),
        "b_w_ukv": w(ks[12], (L, B_KV_LORA, B_HEADS * (B_NOPE + B_V)), B_KV_LORA),
        "w_branch": w(ks[13], (L, N_BRANCHES, BRANCH_WIDTH, D_MODEL), BRANCH_WIDTH),
        "w_mix_out": w(ks[14], (L, D_MODEL, D_MODEL), D_MODEL, beta),
        "ln_xa_g": gain(ks[15], (L, D_MODEL)),
        "ln_xa_b": small(ks[16], (L, D_MODEL)),
        "xa_w_q": w(ks[17], (L, D_MODEL, XA_HEADS * XA_HEAD_DIM), D_MODEL),
        "xa_w_kv": w(ks[18], (L, D_MODEL, 2 * XA_HEADS * XA_HEAD_DIM), D_MODEL),
        "xa_w_o": w(ks[19], (L, XA_HEADS * XA_HEAD_DIM, D_MODEL), XA_HEADS * XA_HEAD_DIM, beta),
        "ln_ffn_g": gain(ks[20], (L, D_MODEL)),
        "ln_ffn_b": small(ks[21], (L, D_MODEL)),
        "ffn_w_gu": w(ks[22], (L, D_MODEL, 2 * FFN_HIDDEN), D_MODEL),
        "ffn_w_down": w(ks[23], (L, FFN_HIDDEN, D_MODEL), FFN_HIDDEN, beta),
    }


def reference(x, mem, positions, ln_mix_g, ln_mix_b, w_in, b_gate, b_forget, a_rel_bias,
              b_q_norm, b_kv_norm, b_w_uq, b_w_ukv, w_branch, w_mix_out, ln_xa_g, ln_xa_b,
              xa_w_q, xa_w_kv, xa_w_o, ln_ffn_g, ln_ffn_b, ffn_w_gu, ffn_w_down):
    alpha = (2 * DEPTH) ** 0.25
    for l in range(DEPTH):
        y = hybrid_mixer(x, positions, w_in[l], b_gate[l], b_forget[l], a_rel_bias[l],
                         b_q_norm[l], b_kv_norm[l], b_w_uq[l], b_w_ukv[l], w_branch[l], w_mix_out[l])
        x = layer_norm(alpha * x + y, ln_mix_g[l], ln_mix_b[l])
        y = memory_cross_attention(x, mem, xa_w_q[l], xa_w_kv[l], xa_w_o[l])
        x = layer_norm(alpha * x + y, ln_xa_g[l], ln_xa_b[l])
        y = swiglu_ffn(x, ffn_w_gu[l], ffn_w_down[l])
        x = layer_norm(alpha * x + y, ln_ffn_g[l], ln_ffn_b[l])
    return x
```

```cpp
#include <hip/hip_runtime.h>
#include <cstdio>
#include <cstdint>
#include <cmath>
namespace nv {
constexpr int T_ = 16384, S_ = 2048, D_ = 1024, NB = 8, INC = 6824, FFH = 2816;
constexpr float ALPHA = 1.4142135623730951f;

__global__ void __launch_bounds__(256) gemm(const float* __restrict__ A, int lda, const float* __restrict__ B, int ldb, float* __restrict__ C, int ldc, int M, int N, int K) {
    __shared__ float As[16][68];
    __shared__ float Bs[16][68];
    const int tid = threadIdx.x, tx = tid & 15, ty = tid >> 4;
    const int m0 = blockIdx.y * 64, n0 = blockIdx.x * 64;
    float acc[4][4];
#pragma unroll
    for (int i = 0; i < 4; ++i)
#pragma unroll
        for (int j = 0; j < 4; ++j) acc[i][j] = 0.f;
    const int am = tid >> 2, ak = (tid & 3) * 4;
    const int bk = tid >> 4, bn = (tid & 15) * 4;
    for (int k0 = 0; k0 < K; k0 += 16) {
        const float4 av = *(const float4*)(A + (size_t)(m0 + am) * lda + k0 + ak);
        float4 bv = make_float4(0.f, 0.f, 0.f, 0.f);
        if (n0 + bn < N) bv = *(const float4*)(B + (size_t)(k0 + bk) * ldb + n0 + bn);
        __syncthreads();
        As[ak + 0][am] = av.x; As[ak + 1][am] = av.y; As[ak + 2][am] = av.z; As[ak + 3][am] = av.w;
        *(float4*)&Bs[bk][bn] = bv;
        __syncthreads();
#pragma unroll
        for (int kk = 0; kk < 16; ++kk) {
            const float4 a = *(const float4*)&As[kk][ty * 4];
            const float4 b = *(const float4*)&Bs[kk][tx * 4];
            const float aa[4] = {a.x, a.y, a.z, a.w}, bb[4] = {b.x, b.y, b.z, b.w};
#pragma unroll
            for (int i = 0; i < 4; ++i)
#pragma unroll
                for (int j = 0; j < 4; ++j) acc[i][j] = fmaf(aa[i], bb[j], acc[i][j]);
        }
    }
    if (n0 + tx * 4 < N) {
#pragma unroll
        for (int i = 0; i < 4; ++i) *(float4*)(C + (size_t)(m0 + ty * 4 + i) * ldc + n0 + tx * 4) = make_float4(acc[i][0], acc[i][1], acc[i][2], acc[i][3]);
    }
}

__device__ __forceinline__ float wsum(float v) {
#pragma unroll
    for (int o = 32; o > 0; o >>= 1) v += __shfl_xor(v, o);
    return v;
}
__device__ __forceinline__ float wmax(float v) {
#pragma unroll
    for (int o = 32; o > 0; o >>= 1) v = fmaxf(v, __shfl_xor(v, o));
    return v;
}

__global__ void rmsnorm(const float* x, int ldx, const float* g, float* out, int ldo, int n, int rows) {
    const int row = blockIdx.x * 4 + (threadIdx.x >> 6), lane = threadIdx.x & 63;
    if (row >= rows) return;
    float s = 0.f;
    for (int i = lane; i < n; i += 64) { const float v = x[(size_t)row * ldx + i]; s += v * v; }
    s = wsum(s);
    const float r = 1.0f / sqrtf(s / (float)n + 1e-6f);
    for (int i = lane; i < n; i += 64) out[(size_t)row * ldo + i] = x[(size_t)row * ldx + i] * r * g[i];
}

__global__ void rope(float* buf, int ld, int off, int hs, int nh, const int* pos, int rows) {
    const int idx = blockIdx.x * blockDim.x + threadIdx.x;
    if (idx >= rows * nh * 16) return;
    const int i = idx & 15, h = (idx >> 4) % nh, row = idx / (16 * nh);
    const double inv = pow(10000.0, -(double)i / 16.0);
    const double ang = (double)pos[row] * inv;
    const float c = (float)cos(ang), s = (float)sin(ang);
    float* p = buf + (size_t)row * ld + off + h * hs;
    const float x1 = p[i], x2 = p[i + 16];
    p[i] = x1 * c - x2 * s; p[i + 16] = x2 * c + x1 * s;
}
__global__ void copy_cols(const float* src, int lds_, int off, float* dst, int ldd, int n, int rows) {
    const int idx = blockIdx.x * blockDim.x + threadIdx.x;
    if (idx >= rows * n) return;
    const int r = idx / n, c = idx % n;
    dst[(size_t)r * ldd + c] = src[(size_t)r * lds_ + off + c];
}
__global__ void fox_cumsum(const float* cf, int ld, const float* bf, float* F) {
    const int h = threadIdx.x;
    if (h >= 8) return;
    double acc = 0.0;
    for (int t = 0; t < S_; ++t) {
        const float z = cf[(size_t)t * ld + h] + bf[h];
        const float ls = fminf(z, 0.f) - log1pf(expf(-fabsf(z)));
        acc += (double)ls; F[h * S_ + t] = (float)acc;
    }
}

__global__ void __launch_bounds__(256) attn(const float* q, int ldq, int qhs, const float* k1, int ldk1, int k1hs, int d1, const float* k2, int ldk2, int d2,
                                            const float* v, int ldv, int vhs, int dv, float* out, int ldo, int ohs, int nh, int nk, float scale, int mode, const float* aux) {
    __shared__ float sc[4][2048];
    __shared__ float qs[4][128];
    const int w = threadIdx.x >> 6, lane = threadIdx.x & 63;
    const int qi = blockIdx.x * 4 + w;
    const int t = qi / nh, h = qi % nh;
    int lo = 0, hi = nk;
    if (mode == 1) { const int c = t >> 6; lo = (c - 8) * 64; if (lo < 0) lo = 0; hi = (c + 1) * 64; }
    else if (mode == 2) { hi = ((t >> 6) + 1) * 64; }
    else if (mode == 3) { hi = t + 1; }
    const int dq = d1 + d2;
    for (int d = lane; d < dq; d += 64) qs[w][d] = q[(size_t)t * ldq + h * qhs + d];
    __syncthreads();
    float mx = -INFINITY;
    for (int s = lo + lane; s < hi; s += 64) {
        const float* kp = k1 + (size_t)s * ldk1 + h * k1hs;
        float a = 0.f;
        for (int d = 0; d < d1; ++d) a = fmaf(qs[w][d], kp[d], a);
        if (d2) { const float* kp2 = k2 + (size_t)s * ldk2; for (int d = 0; d < d2; ++d) a = fmaf(qs[w][d1 + d], kp2[d], a); }
        a *= scale;
        if (mode == 1) { int rel = t - s; rel = rel < -63 ? -63 : (rel > 256 ? 256 : rel); a += aux[h * 320 + rel + 63]; }
        else if (mode == 3) { a += aux[h * S_ + t] - aux[h * S_ + s]; }
        sc[w][s - lo] = a; mx = fmaxf(mx, a);
    }
    mx = wmax(mx);
    float sum = 0.f;
    for (int s = lo + lane; s < hi; s += 64) { const float p = expf(sc[w][s - lo] - mx); sc[w][s - lo] = p; sum += p; }
    sum = wsum(sum);
    __syncthreads();
    const float inv = 1.0f / sum;
    for (int d = lane; d < dv; d += 64) {
        float o = 0.f;
        for (int s = lo; s < hi; ++s) o = fmaf(sc[w][s - lo], v[(size_t)s * ldv + h * vhs + d], o);
        out[(size_t)t * ldo + h * ohs + d] = o * inv;
    }
}

__global__ void gate_merge(const float* hb, int ld, int goff, const float* bg, const float* proj, float* merged, int rows) {
    const int idx = blockIdx.x * blockDim.x + threadIdx.x;
    if (idx >= rows * D_) return;
    const int r = idx / D_, d = idx % D_;
    float acc = 0.f;
    for (int n = 0; n < 3; ++n) {
        const float z = hb[(size_t)r * ld + goff + n * D_ + d] + bg[n * D_ + d];
        acc += (1.0f / (1.0f + expf(-z))) * proj[((size_t)n * rows + r) * D_ + d];
    }
    merged[idx] = acc;
}
__global__ void ln_res(const float* xin, const float* y, const float* g, const float* b, float* xout, int rows) {
    const int row = blockIdx.x * 4 + (threadIdx.x >> 6), lane = threadIdx.x & 63;
    if (row >= rows) return;
    float v[16]; float s = 0.f;
#pragma unroll
    for (int i = 0; i < 16; ++i) { const int c = lane + 64 * i; v[i] = ALPHA * xin[(size_t)row * D_ + c] + y[(size_t)row * D_ + c]; s += v[i]; }
    const float mu = wsum(s) / (float)D_;
    float q = 0.f;
#pragma unroll
    for (int i = 0; i < 16; ++i) { v[i] -= mu; q += v[i] * v[i]; }
    const float r = 1.0f / sqrtf(wsum(q) / (float)D_ + 1e-5f);
#pragma unroll
    for (int i = 0; i < 16; ++i) { const int c = lane + 64 * i; xout[(size_t)row * D_ + c] = v[i] * r * g[c] + b[c]; }
}
__global__ void swiglu(const float* gu, float* hf, int rows) {
    const int idx = blockIdx.x * blockDim.x + threadIdx.x;
    if (idx >= rows * FFH) return;
    const int r = idx / FFH, c = idx % FFH;
    const float g = gu[(size_t)r * 2 * FFH + c], u = gu[(size_t)r * 2 * FFH + FFH + c];
    hf[idx] = g / (1.0f + expf(-g)) * u;
}

static void G(hipStream_t st, const float* A, int lda, const float* B, int ldb, float* C, int ldc, int M, int N, int K) {
    gemm<<<dim3((N + 63) / 64, M / 64), 256, 0, st>>>(A, lda, B, ldb, C, ldc, M, N, K);
}

static void forward(void* const* d_in, float* xres, unsigned char* ws, hipStream_t st, int nbatch_only = -1) {
    const float* x = (const float*)d_in[0]; const float* mem = (const float*)d_in[1]; const int* pos = (const int*)d_in[2];
    auto P = [&](int i, size_t per_layer, int l) { return (const float*)d_in[i] + per_layer * l; };
    size_t off = 0; auto carve = [&](size_t nfloats) { float* p = (float*)(ws + off); off += ((nfloats * 4 + 255) / 256) * 256; return p; };
    float* hb = carve((size_t)S_ * INC);
    float* y = carve((size_t)S_ * 1536);
    float* qn = carve((size_t)S_ * 384);
    float* qb = carve((size_t)S_ * 768);
    float* kvn = carve((size_t)S_ * 256);
    float* kvb = carve((size_t)S_ * 1024);
    float* kpe = carve((size_t)S_ * 32);
    float* F = carve(8 * S_);
    float* proj = carve((size_t)3 * S_ * D_);
    float* merged = carve((size_t)S_ * D_);
    float* yo = carve((size_t)S_ * D_);
    float* xq = carve((size_t)S_ * 512);
    float* xkv = carve((size_t)256 * 1024);
    float* xo = carve((size_t)S_ * 512);
    float* hf = carve((size_t)S_ * FFH);
    hipMemcpyAsync(xres, x, (size_t)T_ * D_ * 4, hipMemcpyDeviceToDevice, st);
    for (int l = 0; l < 2; ++l) {
        const float* w_in = P(5, (size_t)D_ * INC, l); const float* b_gate = P(6, 3 * D_, l); const float* b_forget = P(7, 8, l); const float* relb = P(8, 8 * 320, l);
        const float* qng = P(9, 384, l); const float* kvng = P(10, 256, l); const float* w_uq = P(11, 384 * 768, l); const float* w_ukv = P(12, 256 * 1024, l);
        const float* w_br = P(13, (size_t)3 * 512 * D_, l); const float* w_out = P(14, (size_t)D_ * D_, l);
        const float* wq = P(17, (size_t)D_ * 512, l); const float* wkv = P(18, (size_t)D_ * 1024, l); const float* wo = P(19, (size_t)512 * D_, l);
        const float* wgu = P(22, (size_t)D_ * 2 * FFH, l); const float* wdn = P(23, (size_t)FFH * D_, l);
        for (int b = 0; b < NB; ++b) {
            if (nbatch_only >= 0 && b != nbatch_only) continue;
            float* xb = xres + (size_t)b * S_ * D_; const int* pb = pos + b * S_;
            G(st, xb, D_, w_in, INC, hb, INC, S_, INC, D_);
            attn<<<S_ * 8 / 4, 256, 0, st>>>(hb, INC, 64, hb + 512, INC, 64, 64, nullptr, 0, 0, hb + 1024, INC, 64, 64, y, 1536, 64, 8, S_, 0.125f, 1, relb);
            rmsnorm<<<S_ / 4, 256, 0, st>>>(hb + 1536, INC, qng, qn, 384, 384, S_);
            G(st, qn, 384, w_uq, 768, qb, 768, S_, 768, 384);
            rope<<<(S_ * 8 * 16 + 255) / 256, 256, 0, st>>>(qb, 768, 64, 96, 8, pb, S_);
            rmsnorm<<<S_ / 4, 256, 0, st>>>(hb + 1920, INC, kvng, kvn, 256, 256, S_);
            G(st, kvn, 256, w_ukv, 1024, kvb, 1024, S_, 1024, 256);
            copy_cols<<<(S_ * 32 + 255) / 256, 256, 0, st>>>(hb, INC, 2176, kpe, 32, 32, S_);
            rope<<<(S_ * 16 + 255) / 256, 256, 0, st>>>(kpe, 32, 0, 32, 1, pb, S_);
            attn<<<S_ * 8 / 4, 256, 0, st>>>(qb, 768, 96, kvb, 1024, 128, 64, kpe, 32, 32, kvb + 64, 1024, 128, 64, y + 512, 1536, 64, 8, S_, 0.10206207261596575f, 2, nullptr);
            fox_cumsum<<<1, 64, 0, st>>>(hb + 3744, INC, b_forget, F);
            attn<<<S_ * 8 / 4, 256, 0, st>>>(hb + 2208, INC, 64, hb + 2208 + 512, INC, 64, 64, nullptr, 0, 0, hb + 2208 + 1024, INC, 64, 64, y + 1024, 1536, 64, 8, S_, 0.125f, 3, F);
            for (int n = 0; n < 3; ++n) G(st, y + n * 512, 1536, w_br + (size_t)n * 512 * D_, D_, proj + (size_t)n * S_ * D_, D_, S_, D_, 512);
            gate_merge<<<(S_ * D_ + 255) / 256, 256, 0, st>>>(hb, INC, 3752, b_gate, proj, merged, S_);
            G(st, merged, D_, w_out, D_, yo, D_, S_, D_, D_);
            ln_res<<<S_ / 4, 256, 0, st>>>(xb, yo, P(3, D_, l), P(4, D_, l), xb, S_);
            G(st, xb, D_, wq, 512, xq, 512, S_, 512, D_);
            G(st, mem + (size_t)b * 256 * D_, D_, wkv, 1024, xkv, 1024, 256, 1024, D_);
            attn<<<S_ * 4 / 4, 256, 0, st>>>(xq, 512, 128, xkv, 1024, 128, 128, nullptr, 0, 0, xkv + 512, 1024, 128, 128, xo, 512, 128, 4, 256, 0.08838834764831845f, 4, nullptr);
            G(st, xo, 512, wo, D_, yo, D_, S_, D_, 512);
            ln_res<<<S_ / 4, 256, 0, st>>>(xb, yo, P(15, D_, l), P(16, D_, l), xb, S_);
            G(st, xb, D_, wgu, 2 * FFH, hb, 2 * FFH, S_, 2 * FFH, D_);
            swiglu<<<(S_ * FFH + 255) / 256, 256, 0, st>>>(hb, hf, S_);
            G(st, hf, FFH, wdn, D_, yo, D_, S_, D_, FFH);
            ln_res<<<S_ / 4, 256, 0, st>>>(xb, yo, P(20, D_, l), P(21, D_, l), xb, S_);
        }
    }
}
}
extern "C" void kernel_launch(void* const* d_in, const int* in_sizes, int n_in, void* d_out, int out_size, void* d_ws, size_t ws_size, hipStream_t stream) {
    nv::forward(d_in, (float*)d_out, (unsigned char*)d_ws, stream);
}
```
